# Optimizing an MI355X kernel written in HIP

```python
import jax, jax.numpy as jnp
from jax import lax
import numpy as np

D_MODEL = 1024
BATCH = 16
SEQ = 2048
DEPTH = 4

N_EVEN = (DEPTH + 1) // 2
N_ODD = DEPTH // 2
D_FF = 2816
NORM_EPS = 1e-6

ATTN_HEADS = 8
HEAD_DIM = 64
ATTN_WIDTH = ATTN_HEADS * HEAD_DIM
ROT_DIM = HEAD_DIM // 4
ROPE_THETA = 500000.0
MOBA_BLOCK = 256
MOBA_TOPK = 3
MOBA_Q_CHUNK = 32

LRU_WIDTH = 512
LRU_HEADS = 8
LRU_HEAD_DIM = LRU_WIDTH // LRU_HEADS
LRU_CONV = 4
LRU_C = 8.0

AB_IN = 3 * ATTN_WIDTH + 2 * LRU_WIDTH
AB_OUT = ATTN_WIDTH + LRU_WIDTH

SC_WIDTH = D_MODEL
SC_CONV = 3

kernel_name = "hybrid_rglru_moba_shortconv_macaron"


def rms_norm(x, g):
    xf = x.astype(jnp.float32)
    y = xf * lax.rsqrt(jnp.mean(xf * xf, axis=-1, keepdims=True) + NORM_EPS) * g.astype(jnp.float32)
    return y.astype(x.dtype)


def swiglu(h, w_gate, w_up, w_down):
    return (jax.nn.silu(h @ w_gate) * (h @ w_up)) @ w_down


def causal_depthwise_conv(x, w):
    k, c = w.shape
    return lax.conv_general_dilated(
        x, w[:, None, :].astype(x.dtype), window_strides=(1,), padding=[(k - 1, 0)],
        dimension_numbers=("NWC", "WIO", "NWC"), feature_group_count=c)


def partial_rope(x, pos):
    half = ROT_DIM // 2
    inv_freq = ROPE_THETA ** (-jnp.arange(0, ROT_DIM, 2, dtype=jnp.float32) / ROT_DIM)
    ang = pos[:, None] * inv_freq[None, :]
    cos = jnp.cos(ang)[None, :, None, :]
    sin = jnp.sin(ang)[None, :, None, :]
    xf = x.astype(jnp.float32)
    x1, x2, rest = xf[..., :half], xf[..., half:ROT_DIM], xf[..., ROT_DIM:]
    out = jnp.concatenate([x1 * cos - x2 * sin, x2 * cos + x1 * sin, rest], axis=-1)
    return out.astype(x.dtype)


def moba_attention(q, k, v):
    b, s, h, hd = q.shape
    n_blk = -(-s // MOBA_BLOCK)
    sp = n_blk * MOBA_BLOCK
    pad = ((0, 0), (0, sp - s), (0, 0), (0, 0))
    qt = jnp.pad(q, pad).transpose(0, 2, 1, 3)
    kt = jnp.pad(k, pad).transpose(0, 2, 1, 3)
    vt = jnp.pad(v, pad).transpose(0, 2, 1, 3)
    kb = kt.reshape(b, h, n_blk, MOBA_BLOCK, hd)
    vb = vt.reshape(b, h, n_blk, MOBA_BLOCK, hd)
    kmean = jnp.mean(kb.astype(jnp.float32), axis=3)
    n_sel = min(MOBA_TOPK, n_blk - 1)
    scale = hd ** -0.5
    blk_ids = jnp.arange(n_blk)
    bi = jnp.arange(b)[:, None, None]
    hi = jnp.arange(h)[None, :, None]
    neg = jnp.float32(-1e30)

    def chunk(c):
        start = c * MOBA_Q_CHUNK
        own = start // MOBA_BLOCK
        qc = lax.dynamic_slice_in_dim(qt, start, MOBA_Q_CHUNK, axis=2)
        qpos = start + jnp.arange(MOBA_Q_CHUNK)
        k_own = lax.dynamic_index_in_dim(kb, own, axis=2, keepdims=False)
        v_own = lax.dynamic_index_in_dim(vb, own, axis=2, keepdims=False)
        kpos = own * MOBA_BLOCK + jnp.arange(MOBA_BLOCK)
        s_own = jnp.einsum("bhqd,bhkd->bhqk", qc, k_own).astype(jnp.float32) * scale
        s_own = jnp.where(kpos[None, :] <= qpos[:, None], s_own, neg)
        logits = [s_own]
        vals = [v_own]
        if n_sel > 0:
            g = jnp.einsum("bhqd,bhnd->bhqn", qc.astype(jnp.float32), kmean)
            g = jnp.where(blk_ids < own, g, neg)
            _, idx = lax.top_k(g, n_sel)
            valid = idx < own
            for j in range(n_sel):
                ks = kb[bi, hi, idx[..., j]]
                vs = vb[bi, hi, idx[..., j]]
                sj = jnp.einsum("bhqd,bhqkd->bhqk", qc, ks).astype(jnp.float32) * scale
                logits.append(jnp.where(valid[..., j][..., None], sj, neg))
                vals.append(vs)
        p = jax.nn.softmax(jnp.concatenate(logits, axis=-1), axis=-1)
        p = p.astype(v.dtype)
        out = jnp.einsum("bhqk,bhkd->bhqd", p[..., :MOBA_BLOCK], vals[0])
        for j in range(1, n_sel + 1):
            pj = p[..., j * MOBA_BLOCK:(j + 1) * MOBA_BLOCK]
            out = out + jnp.einsum("bhqk,bhqkd->bhqd", pj, vals[j])
        return out

    outs = lax.map(chunk, jnp.arange(sp // MOBA_Q_CHUNK))
    outs = outs.transpose(1, 0, 3, 2, 4).reshape(b, sp, h, hd)[:, :s]
    return outs.reshape(b, s, h * hd)


def rg_lru(xc, wa, ba, wx, bx, lam):
    b, s, w = xc.shape
    xf = xc.astype(jnp.float32).reshape(b, s, LRU_HEADS, LRU_HEAD_DIM)
    r = jax.nn.sigmoid(jnp.einsum("bshi,hij->bshj", xf, wa.astype(jnp.float32)) + ba.astype(jnp.float32))
    i = jax.nn.sigmoid(jnp.einsum("bshi,hij->bshj", xf, wx.astype(jnp.float32)) + bx.astype(jnp.float32))
    log_a = -LRU_C * r * jax.nn.softplus(-lam.astype(jnp.float32)).reshape(LRU_HEADS, LRU_HEAD_DIM)
    a = jnp.exp(log_a)
    u = jnp.sqrt(-jnp.expm1(2.0 * log_a)) * (i * xf)
    a = a.reshape(b, s, w)
    u = u.reshape(b, s, w)

    def combine(e1, e2):
        a1, u1 = e1
        a2, u2 = e2
        return a1 * a2, a2 * u1 + u2

    _, hseq = lax.associative_scan(combine, (a, u), axis=1)
    return hseq.astype(xc.dtype)


def setup_inputs(seed: int = 0) -> dict:
    key = jax.random.key(seed)
    ks = jax.random.split(key, 24)
    f32 = jnp.float32

    def nrm(k, shape, fan_in):
        return jax.random.normal(k, shape, f32) * (fan_in ** -0.5)

    x = jax.random.normal(ks[0], (BATCH, SEQ, D_MODEL), f32)
    ffn1_w_gate = nrm(ks[1], (DEPTH, D_MODEL, D_FF), D_MODEL)
    ffn1_w_up = nrm(ks[2], (DEPTH, D_MODEL, D_FF), D_MODEL)
    ffn1_w_down = nrm(ks[3], (DEPTH, D_FF, D_MODEL), D_FF)
    ffn2_w_gate = nrm(ks[4], (DEPTH, D_MODEL, D_FF), D_MODEL)
    ffn2_w_up = nrm(ks[5], (DEPTH, D_MODEL, D_FF), D_MODEL)
    ffn2_w_down = nrm(ks[6], (DEPTH, D_FF, D_MODEL), D_FF)
    norm_pre = 1.0 + 0.05 * jax.random.normal(ks[7], (DEPTH, 3, D_MODEL), f32)
    norm_post = 1.0 + 0.05 * jax.random.normal(ks[8], (DEPTH, 3, D_MODEL), f32)
    ab_w_in = nrm(ks[9], (N_EVEN, D_MODEL, AB_IN), D_MODEL)
    ab_w_out = nrm(ks[10], (N_EVEN, AB_OUT, D_MODEL), AB_OUT)
    lru_conv_w = nrm(ks[11], (N_EVEN, LRU_CONV, LRU_WIDTH), LRU_CONV)
    lru_conv_b = 0.01 * jax.random.normal(ks[12], (N_EVEN, LRU_WIDTH), f32)
    lru_gate_a_w = nrm(ks[13], (N_EVEN, LRU_HEADS, LRU_HEAD_DIM, LRU_HEAD_DIM), LRU_HEAD_DIM)
    lru_gate_a_b = 0.01 * jax.random.normal(ks[14], (N_EVEN, LRU_HEADS, LRU_HEAD_DIM), f32)
    lru_gate_x_w = nrm(ks[15], (N_EVEN, LRU_HEADS, LRU_HEAD_DIM, LRU_HEAD_DIM), LRU_HEAD_DIM)
    lru_gate_x_b = 0.01 * jax.random.normal(ks[16], (N_EVEN, LRU_HEADS, LRU_HEAD_DIM), f32)
    a_c = jax.random.uniform(ks[17], (N_EVEN, LRU_WIDTH), f32, 0.9, 0.999)
    a0 = a_c ** (1.0 / LRU_C)
    lru_lambda = jnp.log(a0) - jnp.log1p(-a0)
    c_w_in = nrm(ks[18], (N_ODD, D_MODEL, 3 * SC_WIDTH), D_MODEL)
    c_conv_w = nrm(ks[19], (N_ODD, SC_CONV, SC_WIDTH), SC_CONV)
    c_w_out = nrm(ks[20], (N_ODD, SC_WIDTH, D_MODEL), SC_WIDTH)
    return {
        "x": x,
        "ffn1_w_gate": ffn1_w_gate, "ffn1_w_up": ffn1_w_up, "ffn1_w_down": ffn1_w_down,
        "ffn2_w_gate": ffn2_w_gate, "ffn2_w_up": ffn2_w_up, "ffn2_w_down": ffn2_w_down,
        "norm_pre": norm_pre, "norm_post": norm_post,
        "ab_w_in": ab_w_in, "ab_w_out": ab_w_out,
        "lru_conv_w": lru_conv_w, "lru_conv_b": lru_conv_b,
        "lru_gate_a_w": lru_gate_a_w, "lru_gate_a_b": lru_gate_a_b,
        "lru_gate_x_w": lru_gate_x_w, "lru_gate_x_b": lru_gate_x_b,
        "lru_lambda": lru_lambda,
        "c_w_in": c_w_in, "c_conv_w": c_conv_w, "c_w_out": c_w_out,
    }


def reference(x, ffn1_w_gate, ffn1_w_up, ffn1_w_down, ffn2_w_gate, ffn2_w_up, ffn2_w_down,
              norm_pre, norm_post, ab_w_in, ab_w_out, lru_conv_w, lru_conv_b,
              lru_gate_a_w, lru_gate_a_b, lru_gate_x_w, lru_gate_x_b, lru_lambda,
              c_w_in, c_conv_w, c_w_out):
    b, s, d = x.shape
    pos = jnp.arange(s, dtype=jnp.float32)
    for l in range(DEPTH):
        hdn = swiglu(rms_norm(x, norm_pre[l, 0]), ffn1_w_gate[l], ffn1_w_up[l], ffn1_w_down[l])
        x = x + 0.5 * rms_norm(hdn, norm_post[l, 0])

        h = rms_norm(x, norm_pre[l, 1])
        if l % 2 == 0:
            e = l // 2
            p = h @ ab_w_in[e]
            q = p[..., :ATTN_WIDTH].reshape(b, s, ATTN_HEADS, HEAD_DIM)
            k = p[..., ATTN_WIDTH:2 * ATTN_WIDTH].reshape(b, s, ATTN_HEADS, HEAD_DIM)
            v = p[..., 2 * ATTN_WIDTH:3 * ATTN_WIDTH].reshape(b, s, ATTN_HEADS, HEAD_DIM)
            lru_x = p[..., 3 * ATTN_WIDTH:3 * ATTN_WIDTH + LRU_WIDTH]
            lru_g = p[..., 3 * ATTN_WIDTH + LRU_WIDTH:]
            attn = moba_attention(partial_rope(q, pos), partial_rope(k, pos), v)
            xc = causal_depthwise_conv(lru_x, lru_conv_w[e]) + lru_conv_b[e]
            rec = rg_lru(xc, lru_gate_a_w[e], lru_gate_a_b[e], lru_gate_x_w[e], lru_gate_x_b[e],
                         lru_lambda[e]) * jax.nn.gelu(lru_g)
            mix = jnp.concatenate([attn, rec], axis=-1) @ ab_w_out[e]
        else:
            o = l // 2
            p = h @ c_w_in[o]
            gate_b = p[..., :SC_WIDTH]
            gate_c = p[..., SC_WIDTH:2 * SC_WIDTH]
            xt = p[..., 2 * SC_WIDTH:]
            mix = (gate_b * causal_depthwise_conv(gate_c * xt, c_conv_w[o])) @ c_w_out[o]
        x = x + rms_norm(mix, norm_post[l, 1])

        hdn = swiglu(rms_norm(x, norm_pre[l, 2]), ffn2_w_gate[l], ffn2_w_up[l], ffn2_w_down[l])
        x = x + 0.5 * rms_norm(hdn, norm_post[l, 2])
    return x
```

```cpp
#include <cmath>
#include <hip/hip_runtime.h>
#include <cstdio>
#include <cstdint>
namespace pg8 {
#define PG8_LAS __attribute__((address_space(3)))
typedef unsigned short bf16_t;
typedef short bf16x8 __attribute__((ext_vector_type(8)));
typedef float f32x4 __attribute__((ext_vector_type(4)));
typedef unsigned u32x4 __attribute__((ext_vector_type(4)));
constexpr int BM = 256, BK = 64, HALF = 128, HTB = HALF * BK * 2  , STAGE_BYTES = 8 * HTB, NXCD = 8, WGM = 8;

__host__ __device__ __forceinline__ int lds_byte(int r, int c) { const int st = (r >> 4) * 2 + (c >> 5), rr = r & 15, cc = c & 31, ob = rr * 64 + cc * 2; return st * 1024 + (ob ^ (((ob >> 9) & 1) << 5)); }
__host__ __device__ __forceinline__ void stage_rc(int b, int& R, int& C) { const int st = b / 1024, sb = b % 1024, swz = sb ^ (((sb >> 9) & 1) << 5); R = (st >> 1) * 16 + swz / 64; C = (st & 1) * 32 + (swz % 64) / 2; }
__host__ __device__ __forceinline__ int perm32(int rho) { const int n = rho >> 4, i = rho & 15; return 8 * (i >> 2) + 4 * n + (i & 3); }

struct Unit { int pm, pn; };
struct Gemm { const bf16_t* A; const bf16_t* Bt; int M, N, K; };

struct StaticOrder {
    int nM, nN, nwg, G, c;
    __host__ __device__ void init(int M, int N, int G_, int c_) { nM = M / BM; nN = N / BM; nwg = nM * nN; G = G_; c = c_; }
    __host__ __device__ bool next(int i, Unit& u) const {
        const long L = (long)i * G + c; if (L >= nwg) return false;
        int wgid = (int)L; { const int q = nwg / NXCD, r = nwg % NXCD, xcd = wgid % NXCD, off = wgid / NXCD; wgid = (xcd < r ? xcd * (q + 1) : r * (q + 1) + (xcd - r) * q) + off; }
        const int nig = WGM * nN, gid = wgid / nig, fm = gid * WGM, gsz = (nM - fm) < WGM ? (nM - fm) : WGM;
        u.pm = fm + ((wgid % nig) % gsz); u.pn = (wgid % nig) / gsz; return true;
    }
    __device__ __forceinline__ void a_ready(const Unit&) const {}
    __device__ __forceinline__ void done(const Unit&) const {}
};

__device__ __forceinline__ unsigned cvt_pk_bf16(float lo, float hi) { unsigned r; asm volatile("v_cvt_pk_bf16_f32 %0, %1, %2" : "=v"(r) : "v"(lo), "v"(hi)); return r; }
typedef float f32x2 __attribute__((ext_vector_type(2)));
__device__ __forceinline__ f32x2 gelu_pk(f32x2 v) {
    const f32x2 av = __builtin_elementwise_abs(v), d = av * 0.2316418882f + 1.0f;
    f32x2 t; t.x = __builtin_amdgcn_rcpf(d.x); t.y = __builtin_amdgcn_rcpf(d.y);
    f32x2 q = t * 0.5307027145f + (-0.7265760135f); q = q * t + 0.7107068705f; q = q * t + (-0.142248368f); q = q * t + 0.127414796f; q = q * t;
    const f32x2 s = (v * v) * (-0.72134752044f);
    f32x2 e; e.x = __builtin_amdgcn_exp2f(s.x); e.y = __builtin_amdgcn_exp2f(s.y);
    const f32x2 m = v * (q * e), r = v - m;
    f32x2 o; o.x = v.x < 0.f ? m.x : r.x; o.y = v.y < 0.f ? m.y : r.y; return o;
}

template <int ACT  > struct EpiBf16 {
    static constexpr bool PERM = true, AFTER_DRAIN = false; static_assert(ACT == 0 || ACT == 1, "EpiBf16: ACT is 0 (none) or 1 (gelu_pk)");
    bf16_t* O; int ldc; const float* bias; int split_cols; size_t split_stride; float scale0;
    __device__ __forceinline__ void operator()(const f32x4 (&acc)[2][2][4][2], const Unit& u, int wr, int wc, int fr, int fq) const {
        const int row0 = u.pm * BM + wr * 64 + fr; int colt = u.pn * BM; bf16_t* base = O;
        float sc = 1.f; if (split_cols) { const int t = colt / split_cols; base += (size_t)t * split_stride; colt -= t * split_cols; if (t == 0) sc = scale0; }
        const int col0 = colt + wc * 32 + 8 * fq, bcol0 = u.pn * BM + wc * 32 + 8 * fq;
        f32x4 bv[2][2];
#pragma unroll
        for (int bj = 0; bj < 2; ++bj)
#pragma unroll
            for (int n = 0; n < 2; ++n) bv[bj][n] = bias ? *(const f32x4*)(bias + bcol0 + bj * HALF + 4 * n) : (f32x4){0.f, 0.f, 0.f, 0.f};
#pragma unroll
        for (int ai = 0; ai < 2; ++ai)
#pragma unroll
            for (int m = 0; m < 4; ++m) { bf16_t* rowp = base + (size_t)(row0 + ai * HALF + m * 16) * ldc + col0;
#pragma unroll
                for (int bj = 0; bj < 2; ++bj) { f32x4 v0 = acc[ai][bj][m][0] + bv[bj][0], v1 = acc[ai][bj][m][1] + bv[bj][1];
                    if (ACT == 1) { f32x2 a = gelu_pk((f32x2){v0[0], v0[1]}), b = gelu_pk((f32x2){v0[2], v0[3]}), c = gelu_pk((f32x2){v1[0], v1[1]}), d = gelu_pk((f32x2){v1[2], v1[3]});
                        v0 = (f32x4){a.x, a.y, b.x, b.y}; v1 = (f32x4){c.x, c.y, d.x, d.y}; }
                    v0 = v0 * sc; v1 = v1 * sc; u32x4 w; w.x = cvt_pk_bf16(v0[0], v0[1]); w.y = cvt_pk_bf16(v0[2], v0[3]); w.z = cvt_pk_bf16(v1[0], v1[1]); w.w = cvt_pk_bf16(v1[2], v1[3]);
                    *(u32x4*)(rowp + bj * HALF) = w; } }
    }
};

struct PanelStats {
    unsigned* xbuf;
    unsigned* cnt;
    unsigned* tmo;
    int ntn; float eps;
    unsigned code;
    __device__ __forceinline__ bool run(const f32x4 (&v)[2][2][4][2], const Unit& u, int wr, int wc, int fr, int fq, PG8_LAS unsigned char* lds, int wid, int lane) const {
        typedef float f32x2v __attribute__((ext_vector_type(2)));
        PG8_LAS f32x2v* P = (PG8_LAS f32x2v*)lds;
        PG8_LAS f32x2v* S = (PG8_LAS f32x2v*)(lds + 8192);
        PG8_LAS unsigned* flag = (PG8_LAS unsigned*)(lds + 8192 + 2048);
#pragma unroll
        for (int ai = 0; ai < 2; ++ai)
#pragma unroll
            for (int m = 0; m < 4; ++m) {
                float s = 0.f;
#pragma unroll
                for (int bj = 0; bj < 2; ++bj)
#pragma unroll
                    for (int n = 0; n < 2; ++n) { const f32x4 x = v[ai][bj][m][n]; s += (x[0] + x[1]) + (x[2] + x[3]); }
                s += __shfl_xor(s, 16); s += __shfl_xor(s, 32);
                const float mw = s * (1.0f / 64.0f); float q = 0.f;
#pragma unroll
                for (int bj = 0; bj < 2; ++bj)
#pragma unroll
                    for (int n = 0; n < 2; ++n) { const f32x4 d = v[ai][bj][m][n] - mw; q += (d[0] * d[0] + d[1] * d[1]) + (d[2] * d[2] + d[3] * d[3]); }
                q += __shfl_xor(q, 16); q += __shfl_xor(q, 32);
                if (fq == 0) P[(ai * HALF + wr * 64 + m * 16 + fr) * 4 + wc] = (f32x2v){mw, q};
            }
        asm volatile("s_waitcnt lgkmcnt(0)" ::: "memory"); __builtin_amdgcn_s_barrier(); asm volatile("" ::: "memory");
#if defined(BROKEN_EXCHANGE_NO_WAIT)
#warning BROKEN CONTROL BUILD: the row-statistics exchange does not wait; results are wrong by design
        if (blockIdx.x >= 64) { const long long t0_ = clock64(); while (clock64() - t0_ < 60000) __builtin_amdgcn_s_sleep(8); }
#endif
        const int row = wid * 32 + (lane & 31);
        if (lane < 32) {
            const f32x2v a = P[row * 4 + 0], b = P[row * 4 + 1], c = P[row * 4 + 2], d = P[row * 4 + 3];
            const float mt = (a.x + b.x + c.x + d.x) * 0.25f;
            const float da = a.x - mt, db = b.x - mt, dc = c.x - mt, dd = d.x - mt;
            const float m2 = (a.y + b.y) + (c.y + d.y) + 64.0f * ((da * da + db * db) + (dc * dc + dd * dd));
            unsigned long long* slot = (unsigned long long*)xbuf + ((size_t)(u.pm * BM + row) * 4 + u.pn);
            __hip_atomic_store(slot, ((unsigned long long)__float_as_uint(m2) << 32) | __float_as_uint(mt), __ATOMIC_RELAXED, __HIP_MEMORY_SCOPE_AGENT);
        }
        asm volatile("s_waitcnt vmcnt(0)" ::: "memory");
        if (lane == 0) __hip_atomic_fetch_add(cnt + 64 * u.pm, 1u, __ATOMIC_RELAXED, __HIP_MEMORY_SCOPE_AGENT);
        if (wid == 0) {
            bool dead = false; const unsigned long long t0 = __builtin_amdgcn_s_memrealtime(); const unsigned want = 8u * (unsigned)ntn;
            for (;;) {
#if defined(BROKEN_EXCHANGE_NO_WAIT)
                break;
#endif
                if ((unsigned)__builtin_amdgcn_readfirstlane(__hip_atomic_load(cnt + 64 * u.pm, __ATOMIC_RELAXED, __HIP_MEMORY_SCOPE_AGENT)) >= want) break;
                if (__builtin_amdgcn_s_memrealtime() - t0 > 2000000ull) {
                    if (lane == 0) { unsigned expect = 0u; __hip_atomic_compare_exchange_strong(tmo + 1, &expect, code | (unsigned)(u.pm & 0xff), __ATOMIC_RELAXED, __ATOMIC_RELAXED, __HIP_MEMORY_SCOPE_AGENT);
                                     __hip_atomic_store(tmo, 1u, __ATOMIC_RELAXED, __HIP_MEMORY_SCOPE_AGENT); }
                    dead = true; break; }
                __builtin_amdgcn_s_sleep(2);
            }
            __builtin_amdgcn_fence(__ATOMIC_ACQUIRE, "agent");
            if (lane == 0) flag[0] = dead ? 1u : 0u;
        }
        asm volatile("s_waitcnt vmcnt(0) lgkmcnt(0)" ::: "memory"); __builtin_amdgcn_s_barrier(); asm volatile("" ::: "memory");
        const bool bad = flag[0] != 0u;
        if (lane < 32) {
            const unsigned long long* slot = (const unsigned long long*)xbuf + (size_t)(u.pm * BM + row) * 4; float mt[4], m2[4]; float ms = 0.f;
#pragma unroll
            for (int t = 0; t < 4; ++t) { if (t < ntn) { const unsigned long long w = __hip_atomic_load(slot + t, __ATOMIC_RELAXED, __HIP_MEMORY_SCOPE_AGENT); mt[t] = __uint_as_float((unsigned)w); m2[t] = __uint_as_float((unsigned)(w >> 32)); } else { mt[t] = 0.f; m2[t] = 0.f; } ms += mt[t]; }
            const float mean = ms / (float)ntn; float q = 0.f;
#pragma unroll
            for (int t = 0; t < 4; ++t) if (t < ntn) { const float dm = mt[t] - mean; q += m2[t] + 256.0f * dm * dm; }
            S[row] = (f32x2v){mean, 1.0f / sqrtf(q / (256.0f * (float)ntn) + eps)};
        }
        asm volatile("s_waitcnt lgkmcnt(0)" ::: "memory"); __builtin_amdgcn_s_barrier(); asm volatile("" ::: "memory");
        return bad;
    }
};
struct EpiLnRes {
    static constexpr bool PERM = false, AFTER_DRAIN = true;
    const float* base; float* out; int ldc; const float* bias; PanelStats st; unsigned poison;
    __device__ __forceinline__ void fused(f32x4 (&acc)[2][2][4][2], const Unit& u, int wr, int wc, int fr, int fq, PG8_LAS unsigned char* lds, int wid, int lane) const {
        typedef float f32x2v __attribute__((ext_vector_type(2)));
        const PG8_LAS f32x2v* S = (const PG8_LAS f32x2v*)(lds + 8192);
        const int col0 = u.pn * BM + wc * 32 + 4 * fq;
#pragma unroll
        for (int bj = 0; bj < 2; ++bj)
#pragma unroll
            for (int n = 0; n < 2; ++n) { const f32x4 bv = bias ? *(const f32x4*)(bias + col0 + bj * HALF + n * 16) : (f32x4){0.f, 0.f, 0.f, 0.f};
#pragma unroll
                for (int ai = 0; ai < 2; ++ai)
#pragma unroll
                    for (int m = 0; m < 4; ++m) acc[ai][bj][m][n] += bv; }
        f32x4 pre[4][2][2];
#pragma unroll
        for (int m = 0; m < 4; ++m) { const size_t off = (size_t)(u.pm * BM + wr * 64 + m * 16 + fr) * ldc + col0;
#pragma unroll
            for (int bj = 0; bj < 2; ++bj)
#pragma unroll
                for (int n = 0; n < 2; ++n) pre[m][bj][n] = *(const f32x4*)(base + off + bj * HALF + n * 16); }
        const bool bad = st.run(acc, u, wr, wc, fr, fq, lds, wid, lane) || poison != 0u;
        const float qnan = __builtin_nanf("");
#pragma unroll
        for (int ai = 0; ai < 2; ++ai)
#pragma unroll
            for (int m = 0; m < 4; ++m) { const int r = ai * HALF + wr * 64 + m * 16 + fr; const f32x2v sr = S[r]; const size_t off = (size_t)(u.pm * BM + r) * ldc + col0;
#pragma unroll
                for (int bj = 0; bj < 2; ++bj)
#pragma unroll
                    for (int n = 0; n < 2; ++n) { const f32x4 bs = ai == 0 ? pre[m][bj][n] : *(const f32x4*)(base + off + bj * HALF + n * 16); f32x4 o = bs + (acc[ai][bj][m][n] - sr.x) * sr.y;
                        if (bad) o = (f32x4){qnan, qnan, qnan, qnan}; *(f32x4*)(out + off + bj * HALF + n * 16) = o; }
                if (m & 1) asm volatile("" ::: "memory"); }
    }
};
struct EpiLnResLn {
    static constexpr bool PERM = false, AFTER_DRAIN = true;
    const float* base; float* out; bf16_t* xn; int ldc; const float* bias; PanelStats st1, st2; unsigned poison;
    __device__ __forceinline__ void fused(f32x4 (&acc)[2][2][4][2], const Unit& u, int wr, int wc, int fr, int fq, PG8_LAS unsigned char* lds, int wid, int lane) const {
        typedef float f32x2v __attribute__((ext_vector_type(2))); typedef unsigned u32x2v __attribute__((ext_vector_type(2)));
        const PG8_LAS f32x2v* S = (const PG8_LAS f32x2v*)(lds + 8192);
        const int col0 = u.pn * BM + wc * 32 + 4 * fq;
#pragma unroll
        for (int bj = 0; bj < 2; ++bj)
#pragma unroll
            for (int n = 0; n < 2; ++n) { const f32x4 bv = bias ? *(const f32x4*)(bias + col0 + bj * HALF + n * 16) : (f32x4){0.f, 0.f, 0.f, 0.f};
#pragma unroll
                for (int ai = 0; ai < 2; ++ai)
#pragma unroll
                    for (int m = 0; m < 4; ++m) acc[ai][bj][m][n] += bv; }
        bool bad = st1.run(acc, u, wr, wc, fr, fq, lds, wid, lane) || poison != 0u;
        const float qnan = __builtin_nanf("");
#pragma unroll
        for (int ai = 0; ai < 2; ++ai)
#pragma unroll
            for (int m = 0; m < 4; ++m) { const int r = ai * HALF + wr * 64 + m * 16 + fr; const f32x2v sr = S[r]; const size_t off = (size_t)(u.pm * BM + r) * ldc + col0;
#pragma unroll
                for (int bj = 0; bj < 2; ++bj)
#pragma unroll
                    for (int n = 0; n < 2; ++n) { const f32x4 bs = *(const f32x4*)(base + off + bj * HALF + n * 16); acc[ai][bj][m][n] = bs + (acc[ai][bj][m][n] - sr.x) * sr.y; }
                asm volatile("" : "+v"(acc[ai][0][m][0]), "+v"(acc[ai][0][m][1]), "+v"(acc[ai][1][m][0]), "+v"(acc[ai][1][m][1]));
                if (m & 1) asm volatile("" ::: "memory"); }
        const bool bad1 = bad;
        bad = st2.run(acc, u, wr, wc, fr, fq, lds, wid, lane) || bad;
#pragma unroll
        for (int ai = 0; ai < 2; ++ai)
#pragma unroll
            for (int m = 0; m < 4; ++m) { const int r = ai * HALF + wr * 64 + m * 16 + fr; const f32x2v sr = S[r]; const size_t off = (size_t)(u.pm * BM + r) * ldc + col0;
#pragma unroll
                for (int bj = 0; bj < 2; ++bj)
#pragma unroll
                    for (int n = 0; n < 2; ++n) { const f32x4 x1 = acc[ai][bj][m][n]; *(f32x4*)(out + off + bj * HALF + n * 16) = bad1 ? (f32x4){qnan, qnan, qnan, qnan} : x1;
                        const f32x4 o = (x1 - sr.x) * sr.y; u32x2v w; w.x = cvt_pk_bf16(o[0], o[1]); w.y = cvt_pk_bf16(o[2], o[3]);
                        if (bad) { w.x = 0x7fc07fc0u; w.y = 0x7fc07fc0u; } *(u32x2v*)(xn + off + bj * HALF + n * 16) = w; }
                asm volatile("" ::: "memory"); }
    }
};

template <class Epi, class Sched, bool ALIGN_EPI = false, bool SP2 = false>
__device__ __forceinline__ void gemm_phase(PG8_LAS unsigned char* lds, const Gemm g, const Sched& S, const Epi& E) {
    int tid_ = threadIdx.x; asm volatile("" : "+v"(tid_));
    const int tid = tid_, wid = __builtin_amdgcn_readfirstlane(tid >> 6), lane = tid & 63, wr = wid >> 2, wc = wid & 3, fr = lane & 15, fq = lane >> 4;
    const int K = g.K, nt = K / BK;
    unsigned voffA[2], voffB[2];
#pragma unroll
    for (int i = 0; i < 2; ++i) { int R, C; stage_rc(tid * 16 + i * 8192, R, C); const int Rb = Epi::PERM ? ((R & ~31) + perm32(R & 31)) : R;
        voffA[i] = (unsigned)(R * K + C) * 2u; voffB[i] = (unsigned)(Rb * K + C) * 2u; }
    const size_t kstep = (size_t)(BK * 2);
    const size_t hstep = (size_t)HALF * K * 2;
    const size_t tstep = 2 * hstep;
    const unsigned ldsw = (unsigned)wid * 1024u;
    const int aoff = lds_byte(wr * 64 + fr, fq * 8), boff = lds_byte(wc * 32 + fr, fq * 8);
#define PG8_SA(b, h) (((b) * 2 + (h)) * HTB)
#define PG8_SB(b, h) ((4 + (b) * 2 + (h)) * HTB)
#define PG8_STAGE(bufoff, gbase, voff) do { _Pragma("unroll") for (int _i = 0; _i < 2; ++_i) \
        __builtin_amdgcn_global_load_lds((const unsigned*)((const char*)(gbase) + (voff)[_i]), (PG8_LAS unsigned*)(lds + (bufoff) + ldsw + _i * 8192), 16, 0, 0); } while (0)
#define PG8_LDA(dst, b, h) do { _Pragma("unroll") for (int m = 0; m < 4; ++m) _Pragma("unroll") for (int k = 0; k < 2; ++k) dst[m][k] = *(const PG8_LAS bf16x8*)(lds + PG8_SA(b, h) + aoff + m * 2048 + k * 1024); } while (0)
#define PG8_LDB(dst, b, h) do { _Pragma("unroll") for (int n = 0; n < 2; ++n) _Pragma("unroll") for (int k = 0; k < 2; ++k) dst[n][k] = *(const PG8_LAS bf16x8*)(lds + PG8_SB(b, h) + boff + n * 2048 + k * 1024); } while (0)
#define PG8_MMA(ai, bj, At, Bt) do { __builtin_amdgcn_s_setprio(1); _Pragma("unroll") for (int m = 0; m < 4; ++m) _Pragma("unroll") for (int n = 0; n < 2; ++n) _Pragma("unroll") for (int k = 0; k < 2; ++k) \
        acc[ai][bj][m][n] = __builtin_amdgcn_mfma_f32_16x16x32_bf16(Bt[n][k], At[m][k], acc[ai][bj][m][n], 0, 0, 0); __builtin_amdgcn_s_setprio(0); } while (0)
#define PG8_WAIT_V(n) asm volatile("s_waitcnt vmcnt(" #n ")" ::: "memory")
#define PG8_WAIT_L(n) asm volatile("s_waitcnt lgkmcnt(" #n ")" ::: "memory")
#define PG8_BAR __builtin_amdgcn_s_barrier()
#define PG8_SCHED __builtin_amdgcn_sched_barrier(0)
    Unit cur, nxt; int ui = 0;
    if (!S.next(0, cur)) return;
    f32x4 acc[2][2][4][2];
#pragma unroll
    for (int a = 0; a < 2; ++a)
#pragma unroll
        for (int b = 0; b < 2; ++b)
#pragma unroll
            for (int m = 0; m < 4; ++m)
#pragma unroll
                for (int n = 0; n < 2; ++n) acc[a][b][m][n] = (f32x4){0.f, 0.f, 0.f, 0.f};
    bf16x8 At[4][2], B0[2][2], B1[2][2];
    const char* cA = (const char*)g.A + (size_t)cur.pm * tstep; const char* cB = (const char*)g.Bt + (size_t)cur.pn * tstep;
    S.a_ready(cur);
    if constexpr (SP2) {
        PG8_STAGE(PG8_SB(0, 0), cB, voffB); PG8_STAGE(PG8_SB(0, 1), cB + hstep, voffB); PG8_STAGE(PG8_SA(0, 0), cA, voffA); PG8_STAGE(PG8_SA(0, 1), cA + hstep, voffA);
        if (wr == 1) PG8_BAR;
        PG8_WAIT_V(2); PG8_BAR;
        PG8_STAGE(PG8_SB(1, 0), cB + kstep, voffB); PG8_STAGE(PG8_SA(1, 0), cA + kstep, voffA); PG8_STAGE(PG8_SB(1, 1), cB + hstep + kstep, voffB);
        PG8_WAIT_V(6); PG8_BAR;
    } else {
        PG8_STAGE(PG8_SB(0, 0), cB, voffB); PG8_STAGE(PG8_SA(0, 0), cA, voffA); PG8_STAGE(PG8_SB(0, 1), cB + hstep, voffB); PG8_STAGE(PG8_SA(0, 1), cA + hstep, voffA);
        if (wr == 1) PG8_BAR;
        PG8_WAIT_V(4); PG8_BAR;
        PG8_STAGE(PG8_SB(1, 0), cB + kstep, voffB); PG8_STAGE(PG8_SA(1, 0), cA + kstep, voffA); PG8_STAGE(PG8_SB(1, 1), cB + hstep + kstep, voffB);
        PG8_WAIT_V(6); PG8_BAR;
    }
    for (;;) {
        const bool has_next = S.next(ui + 1, nxt);
        const char* nA = has_next ? (const char*)g.A + (size_t)nxt.pm * tstep : cA; const char* nB = has_next ? (const char*)g.Bt + (size_t)nxt.pn * tstep : cB;
        for (int t = 0; t < nt; t += 2) {
            const bool last = (t == nt - 2);
            const char* a1 = cA + (size_t)(t + 1) * kstep;
            const char* a2 = last ? nA : cA + (size_t)(t + 2) * kstep; const char* b2 = last ? nB : cB + (size_t)(t + 2) * kstep;
            const char* a3 = a2 + kstep; const char* b3 = b2 + kstep;
            if (last && has_next) S.a_ready(nxt);
            if constexpr (SP2) {
            PG8_LDB(B0, 0, 0); PG8_LDB(B1, 0, 1); PG8_SCHED; PG8_LDA(At, 0, 0); PG8_STAGE(PG8_SA(1, 1), a1 + hstep, voffA);
            PG8_WAIT_V(8); PG8_WAIT_L(0); PG8_BAR; PG8_MMA(0, 0, At, B0); PG8_MMA(0, 1, At, B1); PG8_BAR; PG8_SCHED;
            PG8_LDA(At, 0, 1); PG8_STAGE(PG8_SB(0, 0), b2, voffB); PG8_STAGE(PG8_SB(0, 1), b2 + hstep, voffB); PG8_STAGE(PG8_SA(0, 0), a2, voffA);
            PG8_WAIT_V(8); PG8_WAIT_L(0); PG8_BAR; PG8_MMA(1, 0, At, B0); PG8_MMA(1, 1, At, B1); PG8_BAR; PG8_SCHED;
            PG8_LDB(B0, 1, 0); PG8_LDB(B1, 1, 1); PG8_SCHED; PG8_LDA(At, 1, 0); PG8_STAGE(PG8_SA(0, 1), a2 + hstep, voffA);
            PG8_WAIT_V(8); PG8_WAIT_L(0); PG8_BAR; PG8_MMA(0, 0, At, B0); PG8_MMA(0, 1, At, B1); PG8_BAR; PG8_SCHED;
            PG8_LDA(At, 1, 1); PG8_STAGE(PG8_SB(1, 0), b3, voffB); PG8_STAGE(PG8_SB(1, 1), b3 + hstep, voffB); PG8_STAGE(PG8_SA(1, 0), a3, voffA);
            PG8_WAIT_V(8); PG8_WAIT_L(0); PG8_BAR; PG8_MMA(1, 0, At, B0); PG8_MMA(1, 1, At, B1); PG8_BAR; PG8_SCHED;
            } else {
            PG8_LDB(B0, 0, 0); PG8_SCHED; PG8_LDA(At, 0, 0); PG8_STAGE(PG8_SA(1, 1), a1 + hstep, voffA);
            PG8_WAIT_L(8); PG8_BAR; PG8_WAIT_L(0); PG8_MMA(0, 0, At, B0); PG8_BAR; PG8_SCHED;
            PG8_LDB(B1, 0, 1); PG8_STAGE(PG8_SB(0, 0), b2, voffB);
            PG8_BAR; PG8_WAIT_L(0); PG8_MMA(0, 1, At, B1); PG8_BAR;
            PG8_LDA(At, 0, 1); PG8_STAGE(PG8_SA(0, 0), a2, voffA);
            PG8_BAR; PG8_WAIT_L(0); PG8_MMA(1, 0, At, B0); PG8_BAR; PG8_SCHED;
            PG8_STAGE(PG8_SB(0, 1), b2 + hstep, voffB);
            PG8_WAIT_V(6); PG8_BAR; PG8_MMA(1, 1, At, B1); PG8_BAR;
            PG8_LDB(B0, 1, 0); PG8_SCHED; PG8_LDA(At, 1, 0); PG8_STAGE(PG8_SA(0, 1), a2 + hstep, voffA);
            PG8_WAIT_L(8); PG8_BAR; PG8_WAIT_L(0); PG8_MMA(0, 0, At, B0); PG8_BAR; PG8_SCHED;
            PG8_LDB(B1, 1, 1); PG8_STAGE(PG8_SB(1, 0), b3, voffB);
            PG8_BAR; PG8_WAIT_L(0); PG8_MMA(0, 1, At, B1); PG8_BAR;
            PG8_LDA(At, 1, 1); PG8_STAGE(PG8_SA(1, 0), a3, voffA);
            PG8_BAR; PG8_WAIT_L(0); PG8_MMA(1, 0, At, B0); PG8_BAR; PG8_SCHED;
            PG8_STAGE(PG8_SB(1, 1), b3 + hstep, voffB);
            PG8_WAIT_V(6); PG8_BAR; PG8_MMA(1, 1, At, B1); PG8_BAR;
            }
        }
        if constexpr (ALIGN_EPI) { if (wr == 0) PG8_BAR; }
        if constexpr (!Epi::AFTER_DRAIN) { E(acc, cur, wr, wc, fr, fq); S.done(cur); }
        if (!has_next) break;
#pragma unroll
        for (int a = 0; a < 2; ++a)
#pragma unroll
            for (int b = 0; b < 2; ++b)
#pragma unroll
                for (int m = 0; m < 4; ++m)
#pragma unroll
                    for (int n = 0; n < 2; ++n) acc[a][b][m][n] = (f32x4){0.f, 0.f, 0.f, 0.f};
        cur = nxt; cA = nA; cB = nB; ++ui;
        if constexpr (ALIGN_EPI) { if (wr == 1) PG8_BAR; }
    }
    PG8_WAIT_V(0);
    if constexpr (!ALIGN_EPI) { if (wr == 0) PG8_BAR; }
    PG8_BAR;
    if constexpr (Epi::AFTER_DRAIN) { E.fused(acc, cur, wr, wc, fr, fq, lds, wid, lane); S.done(cur); }
#undef PG8_SA
#undef PG8_SB
#undef PG8_STAGE
#undef PG8_LDA
#undef PG8_LDB
#undef PG8_MMA
#undef PG8_WAIT_V
#undef PG8_WAIT_L
#undef PG8_BAR
#undef PG8_SCHED
}
}
#define GAS __attribute__((address_space(1)))
#define LAS __attribute__((address_space(3)))
typedef unsigned short bf16;
typedef unsigned v4u __attribute__((ext_vector_type(4)));
typedef float f32x4 __attribute__((ext_vector_type(4)));
typedef short bf16x8 __attribute__((ext_vector_type(8)));
typedef GAS unsigned gu32;
typedef GAS unsigned long long gu64;
#define RLX_AGENT __ATOMIC_RELAXED, __HIP_MEMORY_SCOPE_AGENT
#define LDS_WAIT() asm volatile("s_waitcnt lgkmcnt(0)" ::: "memory")
#define VM_WAIT() asm volatile("s_waitcnt vmcnt(0)" ::: "memory")
__device__ __forceinline__ unsigned long long rt() { return __builtin_amdgcn_s_memrealtime(); }
__device__ __forceinline__ unsigned f2bf(float f) { unsigned u = __builtin_bit_cast(unsigned, f); return (u + 0x7fffu + ((u >> 16) & 1u)) >> 16; }
__device__ __forceinline__ unsigned pk2(float lo, float hi) { return f2bf(lo) | (f2bf(hi) << 16); }

#define XB_TMO      128
#define XB_XCNT(j)  (256  + 64 * (j))
#define XB_XSUB(j)  (1280 + 64 * (j))
#define XB_XGEN(j)  (2304 + 64 * (j))
#define XB_TOP      3328
#define XB_TOPGEN   3392
#define XCD_BAR_WORDS 3456
#define XB_SPIN_CAP (1u << 18)

__device__ __forceinline__ unsigned xb_ld(unsigned* p)              { return __hip_atomic_load(p, __ATOMIC_RELAXED, __HIP_MEMORY_SCOPE_AGENT); }
__device__ __forceinline__ unsigned xb_add(unsigned* p, unsigned v) { return __hip_atomic_fetch_add(p, v, __ATOMIC_RELAXED, __HIP_MEMORY_SCOPE_AGENT); }
__device__ __forceinline__ unsigned xb_xcc_id() { return (unsigned)__builtin_amdgcn_s_getreg((3 << 11) | 20) & 0xFu; }
#define XB_SPIN(cond, bar) do { unsigned _sp = 0; while (cond) { __builtin_amdgcn_s_sleep(1); \
    if ((++_sp & 255u) == 0u) { if (xb_ld(&(bar)[XB_TMO])) break; if (_sp > XB_SPIN_CAP) { atomicAdd(&(bar)[XB_TMO], 1u); break; } } } } while (0)

struct XcdBarrier {
    unsigned* bar; unsigned x;
    volatile LAS unsigned* st;
};

__device__ __forceinline__ XcdBarrier xcd_barrier_post(unsigned* bar, volatile LAS unsigned* st) {
    XcdBarrier b; b.bar = bar; b.x = xb_xcc_id(); b.st = st;
    if (threadIdx.x == 0) (void)xb_add(&bar[XB_XCNT(b.x)], 1u);
    return b;
}
__device__ __forceinline__ void xcd_barrier_complete(unsigned* bar, unsigned x, unsigned& nloc, unsigned& nx) {
    const unsigned G = gridDim.x * gridDim.y * gridDim.z;
    unsigned sum, cnt, mine, sp = 0u;
    for (;;) {
        sum = 0u; cnt = 0u; mine = 0u;
#pragma unroll
        for (unsigned j = 0; j < 16; ++j) { const unsigned c = xb_ld(&bar[XB_XCNT(j)]); sum += c; cnt += (c > 0u) ? 1u : 0u; mine = (j == x) ? c : mine; }
        if (sum == G) break;
        __builtin_amdgcn_s_sleep(1);
        if ((++sp & 255u) == 0u) { if (xb_ld(&bar[XB_TMO])) break; if (sp > XB_SPIN_CAP) { atomicAdd(&bar[XB_TMO], 1u); break; } }
    }
    nloc = mine > 0u ? mine : 1u; nx = cnt > 0u ? cnt : 1u;
}

__device__ __forceinline__ void xcd_barrier(const XcdBarrier& b) {
    asm volatile("s_waitcnt vmcnt(0)" ::: "memory");
    __syncthreads();
    if (threadIdx.x == 0) {
        unsigned* bar = b.bar;
        __builtin_amdgcn_s_waitcnt(0);
        unsigned nloc = b.st[0], nx = b.st[1];
        if (nloc == 0u) { xcd_barrier_complete(bar, b.x, nloc, nx); b.st[0] = nloc; b.st[1] = nx; }
        const unsigned old = xb_add(&bar[XB_XSUB(b.x)], 1u);
        const unsigned gen = old / nloc;
        if (old + 1u == (gen + 1u) * nloc) {
            __builtin_amdgcn_fence(__ATOMIC_RELEASE, "agent");
            asm volatile("s_waitcnt vmcnt(0)" ::: "memory");
            const unsigned og = xb_add(&bar[XB_TOP], 1u);
            const unsigned tg = og / nx;
            if (og + 1u == (tg + 1u) * nx) xb_add(&bar[XB_TOPGEN], 1u);
            else XB_SPIN(xb_ld(&bar[XB_TOPGEN]) == tg, bar);
            __builtin_amdgcn_fence(__ATOMIC_ACQUIRE, "agent");
            xb_add(&bar[XB_XGEN(b.x)], 1u);
            asm volatile("s_waitcnt vmcnt(0)" ::: "memory");
        } else {
            XB_SPIN(xb_ld(&bar[XB_XGEN(b.x)]) == gen, bar);
            __builtin_amdgcn_fence(__ATOMIC_ACQUIRE, "agent");
            asm volatile("s_waitcnt vmcnt(0)" ::: "memory");
        }
    }
    __syncthreads();
}

constexpr int NWAVES = 8;
constexpr int BATCH = 16, SEQ = 2048, D = 1024, DEPTH = 4, FF = 2816, M = BATCH * SEQ;
constexpr int AW = 512, LW = 512, ABIN = 2560, NH = 8, HD = 64, SCW = 1024;
constexpr float NORM_EPS = 1e-6f;
constexpr float QSCALE = 0.18033688011112042f;

constexpr size_t MiB = 1u << 20;
constexpr size_t WS_CTL = 0, CTL_ZERO_BYTES = 64 * 1024;
constexpr int CW_BAR = 1024;
constexpr size_t WS_ROPE = 1 * MiB;
constexpr size_t SZ_WGU = (size_t)2 * FF * D * 2, SZ_WD = (size_t)D * FF * 2, SZ_FFN = SZ_WGU + SZ_WD;
constexpr size_t SZ_ABIN = (size_t)ABIN * D * 2, SZ_SQ = (size_t)D * D * 2, SZ_CIN = (size_t)3 * SCW * D * 2;
constexpr size_t WS_WFFN = 2 * MiB;
constexpr size_t WS_WABIN = WS_WFFN + 8 * SZ_FFN;
constexpr size_t WS_WABOUT = WS_WABIN + 2 * SZ_ABIN;
constexpr size_t WS_WCIN = WS_WABOUT + 2 * SZ_SQ;
constexpr size_t WS_WCOUT = WS_WCIN + 2 * SZ_CIN;
constexpr size_t WS_WEND = WS_WCOUT + 2 * SZ_SQ;
constexpr size_t WS_XN = 164 * MiB;
constexpr size_t WS_MIX = 228 * MiB;
constexpr size_t WS_BIG = 292 * MiB;
constexpr size_t WS_END = 468 * MiB;
static_assert(WS_WEND <= WS_XN && WS_BIG + (size_t)M * FF * 2 <= WS_END, "d_ws map");
constexpr size_t SZ_T512 = (size_t)M * 512 * 2, SZ_T1024 = (size_t)M * 1024 * 2;

constexpr int RING_BYTES = 131072, LDSCTL_OFF = RING_BYTES, MISC_OFF = LDSCTL_OFF + 320, LDS_BYTES = 147456;

__constant__ double ROPE_INVF[8] = {1.0, 0.19392274474868576, 0.03760603093086393, 0.007292664737217109,
                                    0.001414213562373095, 0.0002742481756762073, 5.318295896944988e-05, 1.031338537721246e-05};

typedef float f32x16 __attribute__((ext_vector_type(16)));
typedef unsigned v2u __attribute__((ext_vector_type(2)));
__device__ __forceinline__ float bf_lo(unsigned w) { return __uint_as_float(w << 16); }
__device__ __forceinline__ float bf_hi(unsigned w) { return __uint_as_float(w & 0xffff0000u); }
__device__ __forceinline__ float bf_us(unsigned short w) { return __uint_as_float((unsigned)w << 16); }
__device__ __forceinline__ unsigned cvtpk(float lo, float hi) { return pg8::cvt_pk_bf16(lo, hi); }
__device__ __forceinline__ float fexp2(float x) { return __builtin_amdgcn_exp2f(x); }
__device__ __forceinline__ float frcp(float x) { return __builtin_amdgcn_rcpf(x); }
__device__ __forceinline__ float fsigmoid(float x) { return frcp(1.0f + fexp2(-1.4426950408889634f * x)); }
__device__ __forceinline__ float fsilu(float x) { return x * fsigmoid(x); }
__device__ __forceinline__ float fgelu_tanh(float x) { return x * fsigmoid(1.5957691216057308f * (x + 0.044715f * x * x * x)); }
__device__ __forceinline__ int crow(int r, int hi) { return (r & 3) + 8 * (r >> 2) + 4 * hi; }
__device__ __forceinline__ float wave_sum(float v) {
#pragma unroll
    for (int o = 1; o < 64; o <<= 1) v += __shfl_xor(v, o);
    return v;
}

namespace pg8 {
struct EpiSwiglu {
    static constexpr bool PERM = true, AFTER_DRAIN = false;
    bf16_t* O; int ldc;
    __device__ __forceinline__ void operator()(const f32x4 (&acc)[2][2][4][2], const Unit& u, int wr, int wc, int fr, int fq) const {
        const int row0 = u.pm * BM + wr * 64 + fr, col0 = u.pn * 128 + wc * 32 + 8 * fq;
#pragma unroll
        for (int ai = 0; ai < 2; ++ai)
#pragma unroll
            for (int m = 0; m < 4; ++m) {
                const f32x4 g0 = acc[ai][0][m][0], g1 = acc[ai][0][m][1], u0 = acc[ai][1][m][0], u1 = acc[ai][1][m][1];
                u32x4 w;
                w.x = cvt_pk_bf16(fsilu(g0[0]) * u0[0], fsilu(g0[1]) * u0[1]); w.y = cvt_pk_bf16(fsilu(g0[2]) * u0[2], fsilu(g0[3]) * u0[3]);
                w.z = cvt_pk_bf16(fsilu(g1[0]) * u1[0], fsilu(g1[1]) * u1[1]); w.w = cvt_pk_bf16(fsilu(g1[2]) * u1[2], fsilu(g1[3]) * u1[3]);
                *(u32x4*)(O + (size_t)(row0 + ai * HALF + m * 16) * ldc + col0) = w;
            }
    }
};
struct EpiPlain {
    static constexpr bool PERM = true, AFTER_DRAIN = false;
    bf16_t* O; int ldc;
    __device__ __forceinline__ void operator()(const f32x4 (&acc)[2][2][4][2], const Unit& u, int wr, int wc, int fr, int fq) const {
        const int row0 = u.pm * BM + wr * 64 + fr, col0 = u.pn * BM + wc * 32 + 8 * fq;
#pragma unroll
        for (int ai = 0; ai < 2; ++ai)
#pragma unroll
            for (int m = 0; m < 4; ++m)
#pragma unroll
                for (int bj = 0; bj < 2; ++bj) {
                    const f32x4 v0 = acc[ai][bj][m][0], v1 = acc[ai][bj][m][1];
                    u32x4 w; w.x = cvt_pk_bf16(v0[0], v0[1]); w.y = cvt_pk_bf16(v0[2], v0[3]); w.z = cvt_pk_bf16(v1[0], v1[1]); w.w = cvt_pk_bf16(v1[2], v1[3]);
                    *(u32x4*)(O + (size_t)(row0 + ai * HALF + m * 16) * ldc + col0 + bj * HALF) = w;
                }
    }
};
struct EpiEven {
    static constexpr bool PERM = true, AFTER_DRAIN = false;
    bf16_t* base; size_t tstride; const float* rope;
    __device__ __forceinline__ void operator()(const f32x4 (&acc)[2][2][4][2], const Unit& u, int wr, int wc, int fr, int fq) const {
        const int type = u.pn >> 1;
        bf16_t* O = base + (size_t)type * tstride;
        const int row0 = u.pm * BM + wr * 64 + fr, col0 = (u.pn & 1) * 256 + wc * 32 + 8 * fq;
        const bool rot = (type < 2) && ((wc & 1) == 0) && (fq < 2);
        const float sc = (type == 0) ? QSCALE : 1.0f;
#pragma unroll
        for (int ai = 0; ai < 2; ++ai)
#pragma unroll
            for (int m = 0; m < 4; ++m) {
                const int row = row0 + ai * HALF + m * 16;
                f32x4 cs = (f32x4){1.f, 1.f, 1.f, 1.f}, sn = (f32x4){0.f, 0.f, 0.f, 0.f};
                if (rot) { const float* rp = rope + (size_t)(row & (SEQ - 1)) * 16 + 4 * fq; cs = *(const f32x4*)rp; sn = *(const f32x4*)(rp + 8); }
#pragma unroll
                for (int bj = 0; bj < 2; ++bj) {
                    f32x4 v0 = acc[ai][bj][m][0], v1 = acc[ai][bj][m][1];
                    if (type < 2) {
                        const f32x4 a0 = v0, a1 = v1;
                        v0[0] = a0[0] * cs[0] - a0[1] * sn[0]; v0[1] = a0[1] * cs[0] + a0[0] * sn[0];
                        v0[2] = a0[2] * cs[1] - a0[3] * sn[1]; v0[3] = a0[3] * cs[1] + a0[2] * sn[1];
                        v1[0] = a1[0] * cs[2] - a1[1] * sn[2]; v1[1] = a1[1] * cs[2] + a1[0] * sn[2];
                        v1[2] = a1[2] * cs[3] - a1[3] * sn[3]; v1[3] = a1[3] * cs[3] + a1[2] * sn[3];
                        v0 = v0 * sc; v1 = v1 * sc;
                    } else if (type == 4) {
#pragma unroll
                        for (int e = 0; e < 4; ++e) { v0[e] = fgelu_tanh(v0[e]); v1[e] = fgelu_tanh(v1[e]); }
                    }
                    u32x4 w; w.x = cvt_pk_bf16(v0[0], v0[1]); w.y = cvt_pk_bf16(v0[2], v0[3]); w.z = cvt_pk_bf16(v1[0], v1[1]); w.w = cvt_pk_bf16(v1[2], v1[3]);
                    *(u32x4*)(O + (size_t)row * 512 + col0 + bj * HALF) = w;
                }
            }
    }
};
struct EpiOdd {
    static constexpr bool PERM = true, AFTER_DRAIN = false;
    bf16_t* CX; bf16_t* BB;
    __device__ __forceinline__ void operator()(const f32x4 (&acc)[2][2][4][2], const Unit& u, int wr, int wc, int fr, int fq) const {
        const int row0 = u.pm * BM + wr * 64 + fr;
        if (u.pn < 8) {
            const int col0 = u.pn * 128 + wc * 32 + 8 * fq;
#pragma unroll
            for (int ai = 0; ai < 2; ++ai)
#pragma unroll
                for (int m = 0; m < 4; ++m) {
                    const f32x4 v0 = acc[ai][0][m][0] * acc[ai][1][m][0], v1 = acc[ai][0][m][1] * acc[ai][1][m][1];
                    u32x4 w; w.x = cvt_pk_bf16(v0[0], v0[1]); w.y = cvt_pk_bf16(v0[2], v0[3]); w.z = cvt_pk_bf16(v1[0], v1[1]); w.w = cvt_pk_bf16(v1[2], v1[3]);
                    *(u32x4*)(CX + (size_t)(row0 + ai * HALF + m * 16) * 1024 + col0) = w;
                }
        } else {
            const int col0 = (u.pn - 8) * BM + wc * 32 + 8 * fq;
#pragma unroll
            for (int ai = 0; ai < 2; ++ai)
#pragma unroll
                for (int m = 0; m < 4; ++m)
#pragma unroll
                    for (int bj = 0; bj < 2; ++bj) {
                        const f32x4 v0 = acc[ai][bj][m][0], v1 = acc[ai][bj][m][1];
                        u32x4 w; w.x = cvt_pk_bf16(v0[0], v0[1]); w.y = cvt_pk_bf16(v0[2], v0[3]); w.z = cvt_pk_bf16(v1[0], v1[1]); w.w = cvt_pk_bf16(v1[2], v1[3]);
                        *(u32x4*)(BB + (size_t)(row0 + ai * HALF + m * 16) * 1024 + col0 + bj * HALF) = w;
                    }
        }
    }
};
}

struct Args { const float* in[21]; float* out; unsigned char* ws; };

__device__ __forceinline__ int dest_row(int mode, int n) {
    if (mode == 1) return ((n >> 7) << 8) + (n & 127);
    if (mode == 2) return ((n >> 7) << 8) + 128 + (n & 127);
    if (mode == 3) {
        if (n < 1024) { const int hl = n & 63; if (hl < 16) return (n - hl) + (hl < 8 ? 2 * hl : 2 * (hl - 8) + 1); }
        return n; }
    if (mode == 4) {
        if (n < 1024) return 2048 + n;
        const int cc = (n - 1024) & 1023;
        return ((cc >> 7) << 8) + (n >= 2048 ? 128 : 0) + (cc & 127); }
    return n;
}
__device__ __forceinline__ void p0_transpose_item(const float* W, int K, int N, bf16* WT, int mode, LAS float* scr, int item, int lane) {
    const int nblk = N / 32, kb = item / nblk, nb = item % nblk, k0 = 64 * kb, n0 = 32 * nb;
#pragma unroll 8
    for (int i = 0; i < 32; ++i) { const int kk = 2 * i + (lane >> 5); scr[kk * 33 + (lane & 31)] = W[(size_t)(k0 + kk) * N + n0 + (lane & 31)]; }
    LDS_WAIT(); asm volatile("" ::: "memory");
    const int c = lane & 7;
#pragma unroll
    for (int j = 0; j < 4; ++j) { const int n = (lane >> 3) + 8 * j; const LAS float* s = scr + (8 * c) * 33 + n;
        v4u o; o.x = pk2(s[0 * 33], s[1 * 33]); o.y = pk2(s[2 * 33], s[3 * 33]); o.z = pk2(s[4 * 33], s[5 * 33]); o.w = pk2(s[6 * 33], s[7 * 33]);
        *(GAS v4u*)(WT + (size_t)dest_row(mode, n0 + n) * K + k0 + 8 * c) = o; }
    LDS_WAIT(); asm volatile("" ::: "memory");
}
__device__ __forceinline__ void p0_prologue(const Args& a, LAS unsigned char* lds, int vcu, int G, int wave, int lane) {
    LAS float* scr = (LAS float*)(lds + wave * 16384);
    const int gw = vcu * NWAVES + wave, NGW = G * NWAVES;
    constexpr int IT_FFN = 1408, N_FFN = 24 * IT_FFN, IT_ABIN = 16 * 80, IT_SQ = 512, IT_CIN = 16 * 96;
    constexpr int NITEMS = N_FFN + 2 * IT_ABIN + 2 * IT_SQ + 2 * IT_CIN + 2 * IT_SQ;
    unsigned char* ws = a.ws;
    for (int it = gw; it < NITEMS; it += NGW) {
        int r = it;
        if (r < N_FFN) {
            const int mi = r / IT_FFN, ii = r % IT_FFN, l = mi / 6, rr = mi % 6, f = rr / 3, which = rr % 3;
            const float* src = a.in[1 + 3 * f + which] + (size_t)l * D * FF;
            bf16* wgu = (bf16*)(ws + WS_WFFN + (size_t)(l * 2 + f) * SZ_FFN);
            if (which == 2) p0_transpose_item(src, FF, D, (bf16*)((unsigned char*)wgu + SZ_WGU), 0, scr, ii, lane);
            else p0_transpose_item(src, D, FF, wgu, which + 1, scr, ii, lane);
            continue; }
        r -= N_FFN;
        if (r < 2 * IT_ABIN) { const int e = r / IT_ABIN; p0_transpose_item(a.in[9] + (size_t)e * D * ABIN, D, ABIN, (bf16*)(ws + WS_WABIN + e * SZ_ABIN), 3, scr, r % IT_ABIN, lane); continue; }
        r -= 2 * IT_ABIN;
        if (r < 2 * IT_SQ) { const int e = r / IT_SQ; p0_transpose_item(a.in[10] + (size_t)e * D * D, D, D, (bf16*)(ws + WS_WABOUT + e * SZ_SQ), 0, scr, r % IT_SQ, lane); continue; }
        r -= 2 * IT_SQ;
        if (r < 2 * IT_CIN) { const int o = r / IT_CIN; p0_transpose_item(a.in[18] + (size_t)o * D * 3 * SCW, D, 3 * SCW, (bf16*)(ws + WS_WCIN + o * SZ_CIN), 4, scr, r % IT_CIN, lane); continue; }
        r -= 2 * IT_CIN;
        { const int o = r / IT_SQ; p0_transpose_item(a.in[20] + (size_t)o * D * D, D, D, (bf16*)(ws + WS_WCOUT + o * SZ_SQ), 0, scr, r % IT_SQ, lane); }
    }
    const int gid = vcu * (NWAVES * 64) + (int)threadIdx.x;
    if (gid < SEQ * 8) {
        const int pos = gid >> 3, i = gid & 7;
        const double ang = (double)pos * ROPE_INVF[i];
        const double twopi = 6.283185307179586476925286766559;
        const double k = __builtin_rint(ang / twopi);
        const double x = ang - k * twopi, x2 = x * x;
        double s = 1.0, c = 1.0;
#pragma unroll
        for (int q = 10; q >= 1; --q) { s = 1.0 - s * x2 / (double)((2 * q) * (2 * q + 1)); c = 1.0 - c * x2 / (double)((2 * q - 1) * (2 * q)); }
        s *= x;
        float* rope = (float*)(ws + WS_ROPE);
        rope[pos * 16 + i] = (float)c; rope[pos * 16 + 8 + i] = (float)s;
    }
}

__device__ __forceinline__ void nr_phase(int vcu, int wave, int lane, const bf16* y, const float* xsrc, float* xdst, float coef, const float* gpost, const float* gpre, bf16* xn) {
    const int gw = vcu * NWAVES + wave;
    f32x4 gp[4], gq[4];
#pragma unroll
    for (int j = 0; j < 4; ++j) { gp[j] = y ? *(const f32x4*)(gpost + 4 * lane + 256 * j) : (f32x4){0.f, 0.f, 0.f, 0.f}; gq[j] = xn ? *(const f32x4*)(gpre + 4 * lane + 256 * j) : (f32x4){0.f, 0.f, 0.f, 0.f}; }
    for (int i = 0; i < 16; ++i) {
        const size_t m = (size_t)4096 * (gw >> 8) + (gw & 255) + 256 * i;
        f32x4 v[4];
#pragma unroll
        for (int j = 0; j < 4; ++j) v[j] = *(const GAS f32x4*)(xsrc + m * D + 4 * lane + 256 * j);
        if (y) {
            v2u yy[4];
#pragma unroll
            for (int j = 0; j < 4; ++j) yy[j] = *(const GAS v2u*)(y + m * D + 4 * lane + 256 * j);
            f32x4 yf[4]; float ss = 0.f;
#pragma unroll
            for (int j = 0; j < 4; ++j) { yf[j] = (f32x4){bf_lo(yy[j].x), bf_hi(yy[j].x), bf_lo(yy[j].y), bf_hi(yy[j].y)}; ss += (yf[j][0] * yf[j][0] + yf[j][1] * yf[j][1]) + (yf[j][2] * yf[j][2] + yf[j][3] * yf[j][3]); }
            const float rs = coef / sqrtf(wave_sum(ss) * (1.0f / D) + NORM_EPS);
#pragma unroll
            for (int j = 0; j < 4; ++j) v[j] = v[j] + yf[j] * gp[j] * rs;
        }
#pragma unroll
        for (int j = 0; j < 4; ++j) *(GAS f32x4*)(xdst + m * D + 4 * lane + 256 * j) = v[j];
        if (xn) {
            float ss = 0.f;
#pragma unroll
            for (int j = 0; j < 4; ++j) ss += (v[j][0] * v[j][0] + v[j][1] * v[j][1]) + (v[j][2] * v[j][2] + v[j][3] * v[j][3]);
            const float rs = 1.0f / sqrtf(wave_sum(ss) * (1.0f / D) + NORM_EPS);
#pragma unroll
            for (int j = 0; j < 4; ++j) { const f32x4 o = v[j] * gq[j] * rs; v2u w; w.x = cvtpk(o[0], o[1]); w.y = cvtpk(o[2], o[3]); *(GAS v2u*)(xn + m * D + 4 * lane + 256 * j) = w; }
        }
    }
}

__device__ __forceinline__ void conv_phase(int vcu, int G, const bf16* BB, const bf16* CX, const float* cw, bf16* Z) {
    const int gid = vcu * (NWAVES * 64) + (int)threadIdx.x, NT = G * NWAVES * 64;
    for (int it = gid; it < (M / 16) * 128; it += NT) {
        const int seg = it >> 7, ch = it & 127;
        const size_t r0 = (size_t)seg * 16;
        float w0[8], w1[8], w2[8];
#pragma unroll
        for (int e = 0; e < 8; ++e) { w0[e] = cw[8 * ch + e]; w1[e] = cw[1024 + 8 * ch + e]; w2[e] = cw[2048 + 8 * ch + e]; }
        float p2[8], p1[8];
        const bool first = ((seg * 16) & (SEQ - 1)) == 0;
        { v4u a = (v4u){0u, 0u, 0u, 0u}, b = a;
          if (!first) { a = *(const GAS v4u*)(CX + (r0 - 2) * 1024 + 8 * ch); b = *(const GAS v4u*)(CX + (r0 - 1) * 1024 + 8 * ch); }
          p2[0] = bf_lo(a.x); p2[1] = bf_hi(a.x); p2[2] = bf_lo(a.y); p2[3] = bf_hi(a.y); p2[4] = bf_lo(a.z); p2[5] = bf_hi(a.z); p2[6] = bf_lo(a.w); p2[7] = bf_hi(a.w);
          p1[0] = bf_lo(b.x); p1[1] = bf_hi(b.x); p1[2] = bf_lo(b.y); p1[3] = bf_hi(b.y); p1[4] = bf_lo(b.z); p1[5] = bf_hi(b.z); p1[6] = bf_lo(b.w); p1[7] = bf_hi(b.w); }
#pragma unroll 8
        for (int i = 0; i < 16; ++i) {
            const v4u c = *(const GAS v4u*)(CX + (r0 + i) * 1024 + 8 * ch), g = *(const GAS v4u*)(BB + (r0 + i) * 1024 + 8 * ch);
            float cu[8], gb[8], z[8];
            cu[0] = bf_lo(c.x); cu[1] = bf_hi(c.x); cu[2] = bf_lo(c.y); cu[3] = bf_hi(c.y); cu[4] = bf_lo(c.z); cu[5] = bf_hi(c.z); cu[6] = bf_lo(c.w); cu[7] = bf_hi(c.w);
            gb[0] = bf_lo(g.x); gb[1] = bf_hi(g.x); gb[2] = bf_lo(g.y); gb[3] = bf_hi(g.y); gb[4] = bf_lo(g.z); gb[5] = bf_hi(g.z); gb[6] = bf_lo(g.w); gb[7] = bf_hi(g.w);
#pragma unroll
            for (int e = 0; e < 8; ++e) { z[e] = gb[e] * (w0[e] * p2[e] + w1[e] * p1[e] + w2[e] * cu[e]); p2[e] = p1[e]; p1[e] = cu[e]; }
            v4u o; o.x = cvtpk(z[0], z[1]); o.y = cvtpk(z[2], z[3]); o.z = cvtpk(z[4], z[5]); o.w = cvtpk(z[6], z[7]);
            *(GAS v4u*)(Z + (r0 + i) * 1024 + 8 * ch) = o;
        }
    }
}

__device__ __forceinline__ void attn_unit(LAS unsigned char* lds, const bf16* Qb, const bf16* Kb, const bf16* Vb, bf16* MIXb, int b, int h, int own) {
    int tid_ = threadIdx.x; asm volatile("" : "+v"(tid_));
    const int tid = tid_, lane = tid & 63, wid = __builtin_amdgcn_readfirstlane(tid >> 6), ql = lane & 31, hi = lane >> 5;
    constexpr int PITCH = 144, TILEB = 64 * PITCH;
    LAS unsigned char* KS = lds; LAS unsigned char* VT = lds + 2 * TILEB;
    LAS float* KMP = (LAS float*)(lds + 4 * TILEB);
    LAS float* KM = KMP + 8 * 7 * 64;
    const size_t rowbase = (size_t)b * SEQ;
    const bf16* qrow = Qb + (rowbase + own * 256 + wid * 32 + ql) * AW + h * HD;
    bf16x8 qf[4];
#pragma unroll
    for (int c = 0; c < 4; ++c) qf[c] = *(const GAS bf16x8*)(qrow + 16 * c + 8 * hi);
    unsigned sel = (1u << own) - 1u;
    if (own >= 4) {
        const int ch = lane & 7;
#pragma unroll
        for (int n = 0; n < 7; ++n) if (n < own) {
            float s[8];
#pragma unroll
            for (int e = 0; e < 8; ++e) s[e] = 0.f;
#pragma unroll
            for (int j = 0; j < 4; ++j) { const v4u w = *(const GAS v4u*)(Kb + (rowbase + n * 256 + (tid >> 3) + 64 * j) * AW + h * HD + 8 * ch);
                s[0] += bf_lo(w.x); s[1] += bf_hi(w.x); s[2] += bf_lo(w.y); s[3] += bf_hi(w.y); s[4] += bf_lo(w.z); s[5] += bf_hi(w.z); s[6] += bf_lo(w.w); s[7] += bf_hi(w.w); }
#pragma unroll
            for (int e = 0; e < 8; ++e) { s[e] += __shfl_xor(s[e], 8); s[e] += __shfl_xor(s[e], 16); s[e] += __shfl_xor(s[e], 32); }
            if (lane < 8) {
#pragma unroll
                for (int e = 0; e < 8; ++e) KMP[(wid * 7 + n) * 64 + 8 * lane + e] = s[e]; }
        }
        __syncthreads();
        if (tid < 448) { const int n = tid >> 6, d = tid & 63; if (n < own) { float t = 0.f;
#pragma unroll
            for (int w = 0; w < 8; ++w) t += KMP[(w * 7 + n) * 64 + d];
            KM[n * 64 + d] = t * (1.0f / 256.0f); } }
        __syncthreads();
        float g[7];
#pragma unroll
        for (int n = 0; n < 7; ++n) { g[n] = -INFINITY; if (n < own) { float acc = 0.f;
#pragma unroll
            for (int c = 0; c < 4; ++c)
#pragma unroll
                for (int e = 0; e < 8; ++e) acc += bf_us((unsigned short)qf[c][e]) * KM[n * 64 + 16 * c + 8 * hi + e];
            g[n] = acc + __shfl_xor(acc, 32); } }
        sel = 0u;
#pragma unroll
        for (int n = 0; n < 7; ++n) if (n < own) { int rank = 0;
#pragma unroll
            for (int mm = 0; mm < 7; ++mm) if (mm != n && mm < own) rank += (g[mm] > g[n] || (g[mm] == g[n] && mm < n)) ? 1 : 0;
            if (rank < 3) sel |= 1u << n; }
    }
    float m_run = -1e30f, l_run = 0.f;
    f32x16 o0, o1;
#pragma unroll
    for (int r = 0; r < 16; ++r) { o0[r] = 0.f; o1[r] = 0.f; }
    const int NT = 4 * (own + 1);
    const int skv = tid >> 3, sch = tid & 7, kv16 = skv & 15;
    const int vpos = (skv & 48) + 8 * ((kv16 >> 2) & 1) + (kv16 & 3) + 4 * ((kv16 >> 3) & 1);
    const bf16* kbase = Kb + (rowbase + skv) * AW + h * HD + 8 * sch;
    const bf16* vbase = Vb + (rowbase + skv) * AW + h * HD + 8 * sch;
#define ATT_KEYROW(ti) (((ti) < 4) ? (own * 256 + 64 * (ti)) : ((((ti) - 4) >> 2) * 256 + 64 * (((ti) - 4) & 3)))
#define ATT_STORE(buf) do { *(LAS v4u*)(KS + (buf) * TILEB + skv * PITCH + sch * 16) = kreg; \
        LAS unsigned char* vt_ = VT + (buf) * TILEB + (8 * sch) * PITCH + vpos * 2; \
        *(LAS unsigned short*)(vt_ + 0 * PITCH) = (unsigned short)(vreg.x & 0xffffu); *(LAS unsigned short*)(vt_ + 1 * PITCH) = (unsigned short)(vreg.x >> 16); \
        *(LAS unsigned short*)(vt_ + 2 * PITCH) = (unsigned short)(vreg.y & 0xffffu); *(LAS unsigned short*)(vt_ + 3 * PITCH) = (unsigned short)(vreg.y >> 16); \
        *(LAS unsigned short*)(vt_ + 4 * PITCH) = (unsigned short)(vreg.z & 0xffffu); *(LAS unsigned short*)(vt_ + 5 * PITCH) = (unsigned short)(vreg.z >> 16); \
        *(LAS unsigned short*)(vt_ + 6 * PITCH) = (unsigned short)(vreg.w & 0xffffu); *(LAS unsigned short*)(vt_ + 7 * PITCH) = (unsigned short)(vreg.w >> 16); } while (0)
    v4u kreg, vreg;
    { const size_t off = (size_t)ATT_KEYROW(0) * AW; kreg = *(const GAS v4u*)(kbase + off); vreg = *(const GAS v4u*)(vbase + off); }
    ATT_STORE(0);
    __syncthreads();
    for (int ti = 0; ti < NT; ++ti) {
        const int buf = ti & 1;
        if (ti + 1 < NT) { const size_t off = (size_t)ATT_KEYROW(ti + 1) * AW; kreg = *(const GAS v4u*)(kbase + off); vreg = *(const GAS v4u*)(vbase + off); }
        const bool ownblk = ti < 4;
        const int blk = ownblk ? own : ((ti - 4) >> 2);
        const bool active = !(ownblk && (64 * ti > 32 * wid + 31));
        if (active) {
            f32x16 p0, p1;
#pragma unroll
            for (int r = 0; r < 16; ++r) { p0[r] = 0.f; p1[r] = 0.f; }
            const LAS unsigned char* kp = KS + buf * TILEB + ql * PITCH + hi * 16;
#pragma unroll
            for (int c = 0; c < 4; ++c) {
                const bf16x8 k0 = *(const LAS bf16x8*)(kp + c * 32), k1 = *(const LAS bf16x8*)(kp + 32 * PITCH + c * 32);
                p0 = __builtin_amdgcn_mfma_f32_32x32x16_bf16(k0, qf[c], p0, 0, 0, 0);
                p1 = __builtin_amdgcn_mfma_f32_32x32x16_bf16(k1, qf[c], p1, 0, 0, 0);
            }
            if (ownblk) {
                if (64 * ti + 63 > 32 * wid) { const int qpos = 32 * wid + ql;
#pragma unroll
                    for (int r = 0; r < 16; ++r) { const int kvp = 64 * ti + crow(r, hi); if (kvp > qpos) p0[r] = -1e30f; if (kvp + 32 > qpos) p1[r] = -1e30f; } }
            } else if (!((sel >> blk) & 1u)) {
#pragma unroll
                for (int r = 0; r < 16; ++r) { p0[r] = -1e30f; p1[r] = -1e30f; }
            }
            float mt = fmaxf(p0[0], p1[0]);
#pragma unroll
            for (int r = 1; r < 16; ++r) mt = fmaxf(mt, fmaxf(p0[r], p1[r]));
            mt = fmaxf(mt, __shfl_xor(mt, 32));
            const float m_new = fmaxf(m_run, mt), alpha = fexp2(m_run - m_new);
            m_run = m_new;
            float ls = 0.f;
#pragma unroll
            for (int r = 0; r < 16; ++r) { p0[r] = fexp2(p0[r] - m_new); p1[r] = fexp2(p1[r] - m_new); ls += p0[r] + p1[r]; }
            l_run = l_run * alpha + ls;
#pragma unroll
            for (int r = 0; r < 16; ++r) { o0[r] *= alpha; o1[r] *= alpha; }
            v4u pw[4];
            pw[0] = (v4u){cvtpk(p0[0], p0[1]), cvtpk(p0[2], p0[3]), cvtpk(p0[4], p0[5]), cvtpk(p0[6], p0[7])};
            pw[1] = (v4u){cvtpk(p0[8], p0[9]), cvtpk(p0[10], p0[11]), cvtpk(p0[12], p0[13]), cvtpk(p0[14], p0[15])};
            pw[2] = (v4u){cvtpk(p1[0], p1[1]), cvtpk(p1[2], p1[3]), cvtpk(p1[4], p1[5]), cvtpk(p1[6], p1[7])};
            pw[3] = (v4u){cvtpk(p1[8], p1[9]), cvtpk(p1[10], p1[11]), cvtpk(p1[12], p1[13]), cvtpk(p1[14], p1[15])};
            const LAS unsigned char* vp = VT + buf * TILEB + ql * PITCH + hi * 16;
#pragma unroll
            for (int cc = 0; cc < 4; ++cc) {
                const bf16x8 v0 = *(const LAS bf16x8*)(vp + cc * 32), v1 = *(const LAS bf16x8*)(vp + 32 * PITCH + cc * 32);
                const bf16x8 pf = __builtin_bit_cast(bf16x8, pw[cc]);
                o0 = __builtin_amdgcn_mfma_f32_32x32x16_bf16(v0, pf, o0, 0, 0, 0);
                o1 = __builtin_amdgcn_mfma_f32_32x32x16_bf16(v1, pf, o1, 0, 0, 0);
            }
        }
        if (ti + 1 < NT) ATT_STORE(buf ^ 1);
        __syncthreads();
    }
#undef ATT_KEYROW
#undef ATT_STORE
    const float lt = l_run + __shfl_xor(l_run, 32), inv = 1.0f / lt;
    bf16* orow = MIXb + (rowbase + own * 256 + wid * 32 + ql) * D + h * HD;
#pragma unroll
    for (int g = 0; g < 4; ++g) {
        v2u w0, w1;
        w0.x = cvtpk(o0[4 * g] * inv, o0[4 * g + 1] * inv); w0.y = cvtpk(o0[4 * g + 2] * inv, o0[4 * g + 3] * inv);
        w1.x = cvtpk(o1[4 * g] * inv, o1[4 * g + 1] * inv); w1.y = cvtpk(o1[4 * g + 2] * inv, o1[4 * g + 3] * inv);
        *(GAS v2u*)(orow + 8 * g + 4 * hi) = w0; *(GAS v2u*)(orow + 32 + 8 * g + 4 * hi) = w1;
    }
}

__device__ __forceinline__ void lru_unit(LAS unsigned char* lds, const Args& a, const bf16* LX, const bf16* LG, bf16* MIXb, int e_, int b, int h, int jb) {
    int tid_ = threadIdx.x; asm volatile("" : "+v"(tid_));
    const int tid = tid_, lane = tid & 63, wid = __builtin_amdgcn_readfirstlane(tid >> 6), jl = lane & 31, hi = lane >> 5;
    constexpr int PITCH = 144;
    LAS unsigned char* XC = lds + wid * (32 * PITCH);
    LAS float* CARRY = (LAS float*)(lds + 8 * 32 * PITCH);
    LAS float* CWL = (LAS float*)(lds + 8 * 32 * PITCH + 2048);
    LAS v4u* GWL = (LAS v4u*)(lds + 8 * 32 * PITCH + 2048 + 1280);
    const int chn = h * 64 + 32 * jb + jl;
    {
        const float* Wa = a.in[13] + (size_t)(e_ * 8 + h) * 64 * 64;
        const float* Wx = a.in[15] + (size_t)(e_ * 8 + h) * 64 * 64;
        if (wid == 0) {
#pragma unroll
            for (int c = 0; c < 4; ++c) {
                float ta[8], tx[8];
#pragma unroll
                for (int ee = 0; ee < 8; ++ee) { const int i = 16 * c + 8 * hi + ee; ta[ee] = Wa[i * 64 + 32 * jb + jl]; tx[ee] = Wx[i * 64 + 32 * jb + jl]; }
                GWL[c * 64 + lane] = (v4u){cvtpk(ta[0], ta[1]), cvtpk(ta[2], ta[3]), cvtpk(ta[4], ta[5]), cvtpk(ta[6], ta[7])};
                GWL[(4 + c) * 64 + lane] = (v4u){cvtpk(tx[0], tx[1]), cvtpk(tx[2], tx[3]), cvtpk(tx[4], tx[5]), cvtpk(tx[6], tx[7])};
            }
        }
        if (tid < 320) CWL[tid] = (tid < 256) ? a.in[11][(size_t)(e_ * 4 + (tid >> 6)) * 512 + h * 64 + (tid & 63)] : a.in[12][e_ * 512 + h * 64 + (tid & 63)];
        __syncthreads();
    }
    const float bias_a = a.in[14][e_ * 512 + chn], bias_x = a.in[16][e_ * 512 + chn];
    const float sp8 = 8.0f * log1pf(expf(-a.in[17][e_ * 512 + chn])) * 1.4426950408889634f;
    const int tl = lane >> 3, cc = lane & 7;
    const size_t rowbase = (size_t)b * SEQ;
    float carry_in = 0.f;
    for (int pass = 0; pass < 2; ++pass) {
        float hc = carry_in, Ptot = 1.f;
        for (int st = 0; st < 8; ++st) {
            const int t0 = 256 * wid + 32 * st;
            {
                v4u xin[7];
#pragma unroll
                for (int q = 0; q < 7; ++q) { const int tt = t0 + 4 * tl - 3 + q; xin[q] = (v4u){0u, 0u, 0u, 0u}; if (tt >= 0) xin[q] = *(const GAS v4u*)(LX + (rowbase + tt) * LW + h * 64 + 8 * cc); }
                float acc[4][8];
                { const f32x4 b0 = *(const LAS f32x4*)(CWL + 256 + 8 * cc), b1 = *(const LAS f32x4*)(CWL + 256 + 8 * cc + 4);
#pragma unroll
                  for (int i = 0; i < 4; ++i) { acc[i][0] = b0[0]; acc[i][1] = b0[1]; acc[i][2] = b0[2]; acc[i][3] = b0[3]; acc[i][4] = b1[0]; acc[i][5] = b1[1]; acc[i][6] = b1[2]; acc[i][7] = b1[3]; } }
#pragma unroll
                for (int tap = 0; tap < 4; ++tap) {
                    const f32x4 w0 = *(const LAS f32x4*)(CWL + tap * 64 + 8 * cc), w1 = *(const LAS f32x4*)(CWL + tap * 64 + 8 * cc + 4);
#pragma unroll
                    for (int i = 0; i < 4; ++i) { const v4u w = xin[i + tap];
                        acc[i][0] += w0[0] * bf_lo(w.x); acc[i][1] += w0[1] * bf_hi(w.x); acc[i][2] += w0[2] * bf_lo(w.y); acc[i][3] += w0[3] * bf_hi(w.y);
                        acc[i][4] += w1[0] * bf_lo(w.z); acc[i][5] += w1[1] * bf_hi(w.z); acc[i][6] += w1[2] * bf_lo(w.w); acc[i][7] += w1[3] * bf_hi(w.w); }
                }
#pragma unroll
                for (int i = 0; i < 4; ++i)
                    *(LAS v4u*)(XC + (4 * tl + i) * PITCH + cc * 16) = (v4u){cvtpk(acc[i][0], acc[i][1]), cvtpk(acc[i][2], acc[i][3]), cvtpk(acc[i][4], acc[i][5]), cvtpk(acc[i][6], acc[i][7])};
            }
            asm volatile("s_waitcnt lgkmcnt(0)" ::: "memory");
            f32x16 da, dx;
#pragma unroll
            for (int r = 0; r < 16; ++r) { da[r] = 0.f; dx[r] = 0.f; }
#pragma unroll
            for (int c = 0; c < 4; ++c) {
                const bf16x8 af = *(const LAS bf16x8*)(XC + jl * PITCH + (16 * c + 8 * hi) * 2);
                const bf16x8 wa = __builtin_bit_cast(bf16x8, GWL[c * 64 + lane]), wx = __builtin_bit_cast(bf16x8, GWL[(4 + c) * 64 + lane]);
                da = __builtin_amdgcn_mfma_f32_32x32x16_bf16(af, wa, da, 0, 0, 0);
                dx = __builtin_amdgcn_mfma_f32_32x32x16_bf16(af, wx, dx, 0, 0, 0);
            }
#pragma unroll
            for (int g = 0; g < 4; ++g) {
                float P = 1.f, Q = 0.f, hl[4], cp[4];
#pragma unroll
                for (int i = 0; i < 4; ++i) {
                    const int r = 4 * g + i;
                    const float xcv = bf_us(*(const LAS unsigned short*)(XC + crow(r, hi) * PITCH + (32 * jb + jl) * 2));
                    const float rg = fsigmoid(da[r] + bias_a), ig = fsigmoid(dx[r] + bias_x);
                    const float aa = fexp2(-sp8 * rg);
                    const float uu = sqrtf(fmaxf(1.0f - aa * aa, 0.f)) * ig * xcv;
                    Q = aa * Q + uu; P *= aa; hl[i] = Q; cp[i] = P;
                }
                const float oP = __shfl_xor(P, 32), oQ = __shfl_xor(Q, 32);
                const float P0 = hi ? oP : P, Q0 = hi ? oQ : Q, P1 = hi ? P : oP, Q1 = hi ? Q : oQ;
                const float mid = P0 * hc + Q0, hin = hi ? mid : hc;
                hc = P1 * mid + Q1; Ptot *= P0 * P1;
                if (pass == 1) {
#pragma unroll
                    for (int i = 0; i < 4; ++i) {
                        const size_t row = rowbase + t0 + crow(4 * g + i, hi);
                        const float gg = bf_us(*(const GAS unsigned short*)(LG + row * LW + chn));
                        *(GAS unsigned short*)(MIXb + row * D + 512 + chn) = (unsigned short)(cvtpk((hl[i] + cp[i] * hin) * gg, 0.f) & 0xffffu);
                    }
                }
            }
            asm volatile("s_waitcnt lgkmcnt(0)" ::: "memory");
        }
        if (pass == 0) {
            if (hi == 0) { CARRY[(wid * 32 + jl) * 2] = Ptot; CARRY[(wid * 32 + jl) * 2 + 1] = hc; }
            __syncthreads();
            carry_in = 0.f;
            for (int w = 0; w < wid; ++w) carry_in = CARRY[(w * 32 + jl) * 2] * carry_in + CARRY[(w * 32 + jl) * 2 + 1];
        }
    }
}

__global__ void __launch_bounds__(NWAVES * 64, 2) hybrid_fwd(Args args) {
    extern __shared__ __attribute__((aligned(16))) unsigned char lds_raw[];
    LAS unsigned char* lds = (LAS unsigned char*)lds_raw;
    volatile LAS unsigned* MISC = (volatile LAS unsigned*)(lds + MISC_OFF);
    const int tid = threadIdx.x, lane = tid & 63, wave = __builtin_amdgcn_readfirstlane(tid >> 6);
    const int G = gridDim.x, bx = blockIdx.x;
    const int vcu = (G % 8 == 0) ? (bx % 8) * (G / 8) + bx / 8 : bx;
    unsigned char* ws = args.ws;
    gu32* ctl = (gu32*)(ws + WS_CTL);
    for (int u = tid; u < (LDS_BYTES - LDSCTL_OFF) / 4; u += NWAVES * 64) ((LAS unsigned*)(lds + LDSCTL_OFF))[u] = 0u;
    __syncthreads();
    XcdBarrier bar = xcd_barrier_post((unsigned*)(ctl + CW_BAR), MISC + 8);
    if (G != 256) return;

    bf16* XN = (bf16*)(ws + WS_XN); bf16* MIX = (bf16*)(ws + WS_MIX); bf16* BIG = (bf16*)(ws + WS_BIG);
    const float* rope = (const float*)(ws + WS_ROPE);
    float* X = args.out;

    p0_prologue(args, lds, vcu, G, wave, lane);
    nr_phase(vcu, wave, lane, nullptr, args.in[0], X, 0.f, nullptr, args.in[7], XN);
    xcd_barrier(bar);


#ifdef NO_LRU
#define LRU_CALL
#else
#define LRU_CALL lru_unit(lds, args, LXb, LGb, MIX, e, vcu >> 4, (vcu >> 1) & 7, vcu & 1);
#endif
#ifdef NO_ATTN
#define ATTN_CALL(o_)
#else
#define ATTN_CALL(o_) attn_unit(lds, Qb, Kb, Vb, MIX, bh >> 3, bh & 7, (o_)); __syncthreads();
#endif
#define OUT_GEMM_NR(s_, Aop, Wop, Kop) do { \
        { pg8::Gemm g{(Aop), (Wop), M, D, (Kop)}; pg8::StaticOrder S; S.init(M, D, G, bx); pg8::EpiPlain E{XN, D}; \
          pg8::gemm_phase<pg8::EpiPlain, pg8::StaticOrder, true, true>(lds, g, S, E); } \
        xcd_barrier(bar); \
        { const int ss_ = (s_); const bool lastp = (ss_ == 3 * DEPTH - 1); \
          nr_phase(vcu, wave, lane, XN, X, X, (ss_ % 3) == 1 ? 1.0f : 0.5f, args.in[8] + (size_t)ss_ * D, lastp ? nullptr : args.in[7] + (size_t)(ss_ + 1) * D, lastp ? nullptr : XN); \
          if (!lastp) xcd_barrier(bar); } } while (0)
#define FFN_SUB(l_, f_) do { \
        const bf16* wgu = (const bf16*)(ws + WS_WFFN + (size_t)((l_) * 2 + (f_)) * SZ_FFN); \
        { pg8::Gemm g{XN, wgu, M, 2 * FF, D}; pg8::StaticOrder S; S.init(M, 2 * FF, G, bx); pg8::EpiSwiglu E{BIG, FF}; \
          pg8::gemm_phase<pg8::EpiSwiglu, pg8::StaticOrder, true, true>(lds, g, S, E); } \
        xcd_barrier(bar); \
        OUT_GEMM_NR((l_) * 3 + 2 * (f_), BIG, (const bf16*)((const unsigned char*)wgu + SZ_WGU), FF); } while (0)
#define EVEN_SUB(l_) do { const int e = (l_) >> 1; \
        { pg8::Gemm g{XN, (const bf16*)(ws + WS_WABIN + e * SZ_ABIN), M, ABIN, D}; pg8::StaticOrder S; S.init(M, ABIN, G, bx); pg8::EpiEven E{BIG, (size_t)M * 512, rope}; \
          pg8::gemm_phase<pg8::EpiEven, pg8::StaticOrder, true, true>(lds, g, S, E); } \
        xcd_barrier(bar); \
        { const bf16* Qb = BIG; const bf16* Kb = BIG + (size_t)M * 512; const bf16* Vb = BIG + (size_t)2 * M * 512; \
          const bf16* LXb = BIG + (size_t)3 * M * 512; const bf16* LGb = BIG + (size_t)4 * M * 512; \
          LRU_CALL \
          __syncthreads(); \
          for (int i = 0; i < 2; ++i) { const int p = vcu * 2 + i, bh = p >> 2, pr = p & 3; \
              ATTN_CALL(7 - pr) \
              ATTN_CALL(pr) } } \
        xcd_barrier(bar); \
        OUT_GEMM_NR((l_) * 3 + 1, MIX, (const bf16*)(ws + WS_WABOUT + e * SZ_SQ), D); } while (0)
#define ODD_SUB(l_) do { const int o = (l_) >> 1; \
        { pg8::Gemm g{XN, (const bf16*)(ws + WS_WCIN + o * SZ_CIN), M, 3 * SCW, D}; pg8::StaticOrder S; S.init(M, 3 * SCW, G, bx); pg8::EpiOdd E{BIG, BIG + (size_t)M * 1024}; \
          pg8::gemm_phase<pg8::EpiOdd, pg8::StaticOrder, true, true>(lds, g, S, E); } \
        xcd_barrier(bar); \
        conv_phase(vcu, G, BIG + (size_t)M * 1024, BIG, args.in[19] + (size_t)o * 3 * SCW, MIX); \
        xcd_barrier(bar); \
        OUT_GEMM_NR((l_) * 3 + 1, MIX, (const bf16*)(ws + WS_WCOUT + o * SZ_SQ), D); } while (0)

#ifndef PROGRAM
#define PROGRAM FFN_SUB(0, 0); EVEN_SUB(0); FFN_SUB(0, 1); FFN_SUB(1, 0); ODD_SUB(1); FFN_SUB(1, 1); FFN_SUB(2, 0); EVEN_SUB(2); FFN_SUB(2, 1); FFN_SUB(3, 0); ODD_SUB(3); FFN_SUB(3, 1);
#endif
    PROGRAM
}

extern "C" void kernel_launch(void* const* d_in, const int* in_sizes, int n_in, void* d_out, int out_size, void* d_ws, size_t ws_size, hipStream_t stream) {
    static int grid = 0;
    if (grid == 0) {
        if (n_in != 21 || in_sizes[0] != M * D || out_size != M * D || ws_size < WS_END) {
            fprintf(stderr, "kernel_launch: unexpected shapes (n_in %d, in0 %d, out %d, ws %zu; need ws >= %zu); nothing launched\n", n_in, n_in > 0 ? in_sizes[0] : -1, out_size, ws_size, (size_t)WS_END);
            grid = -1; return; }
        int dev = 0, cus = 0, per_cu = 0;
        if (hipGetDevice(&dev) != hipSuccess || hipDeviceGetAttribute(&cus, hipDeviceAttributeMultiprocessorCount, dev) != hipSuccess) { grid = -1; return; }
        if (hipFuncSetAttribute((const void*)hybrid_fwd, hipFuncAttributeMaxDynamicSharedMemorySize, LDS_BYTES) != hipSuccess) { fprintf(stderr, "kernel_launch: hipFuncSetAttribute failed\n"); grid = -1; return; }
        if (hipOccupancyMaxActiveBlocksPerMultiprocessor(&per_cu, (const void*)hybrid_fwd, NWAVES * 64, LDS_BYTES) != hipSuccess || per_cu < 1)
            fprintf(stderr, "kernel_launch: note: occupancy query reports %d workgroups per CU\n", per_cu);
        (void)hipGetLastError();
        grid = cus;
        if (grid != 256) fprintf(stderr, "kernel_launch: %d CUs; this kernel is dealt for 256\n", grid);
    }
    if (grid < 0) return;
    if (hipMemsetAsync((char*)d_ws + WS_CTL, 0, CTL_ZERO_BYTES, stream) != hipSuccess) return;
    Args a{};
    for (int i = 0; i < 21; ++i) a.in[i] = (const float*)d_in[i];
    a.out = (float*)d_out; a.ws = (unsigned char*)d_ws;
    hipLaunchKernelGGL(hybrid_fwd, dim3(grid), dim3(NWAVES * 64), LDS_BYTES, stream, a);
}
```
